# Optimizing an MI355X kernel written in HIP

```python
import jax, jax.numpy as jnp
from jax import lax

D_MODEL = 1024
BATCH = 4
SEQ = 4096
DEPTH = 1

N_ATTN_HEADS = 8
HEAD_DIM = 64
ATTN_WIDTH = N_ATTN_HEADS * HEAD_DIM
N_CONV_GROUPS = 8
CONV_GROUP_DIM = 64
CONV_WIDTH = N_CONV_GROUPS * CONV_GROUP_DIM
CONV_KSIZE = 3
D_FF = 2816
Q_BLOCK = 128
N_SUBLAYERS = 3
N_MOD = 3
EPS = 1e-6
FFN_RES_WEIGHT = 0.5
MIX_IN_WIDTH = 3 * CONV_WIDTH + 3 * ATTN_WIDTH + 2 * D_MODEL

kernel_name = "hybrid_shortconv_stickbreaking_macaron_block"


def rmsnorm(x, g):
    xf = x.astype(jnp.float32)
    inv = lax.rsqrt(jnp.mean(xf * xf, axis=-1, keepdims=True) + EPS)
    return (xf * inv).astype(x.dtype) * g


def modulate(x, shift, scale):
    return x * (1 + scale[:, None, :]) + shift[:, None, :]


def swiglu(x, w_gu, w_down):
    g, u = jnp.split(x @ w_gu, 2, axis=-1)
    return (jax.nn.silu(g) * u) @ w_down


def short_conv(b_gate, c_gate, xin, conv_w):
    v = c_gate * xin
    S = v.shape[1]
    vp = jnp.pad(v, ((0, 0), (CONV_KSIZE - 1, 0), (0, 0)))
    y = conv_w[0] * vp[:, 0:S, :]
    for k in range(1, CONV_KSIZE):
        y = y + conv_w[k] * vp[:, k:k + S, :]
    return b_gate * y


def stick_breaking_attention(q, k, v):
    S = q.shape[2]
    scale = HEAD_DIM ** -0.5
    qf = q.astype(jnp.float32)
    kf = k.astype(jnp.float32)
    vf = v.astype(jnp.float32)
    outs = []
    for i in range(S // Q_BLOCK):
        start = i * Q_BLOCK
        end = start + Q_BLOCK
        q_blk = qf[:, :, start:end, :]
        k_c = kf[:, :, :end, :]
        v_c = vf[:, :, :end, :]
        z = jnp.einsum('bhqd,bhkd->bhqk', q_blk, k_c) * scale
        t_pos = start + jnp.arange(Q_BLOCK)
        s_pos = jnp.arange(end)
        valid = s_pos[None, :] < t_pos[:, None]
        sp = jnp.where(valid, jax.nn.softplus(z), 0.0)
        rem = lax.cumsum(sp, axis=3, reverse=True) - sp
        log_a = jax.nn.log_sigmoid(z) - rem
        a = jnp.where(valid, jnp.exp(log_a), 0.0)
        outs.append(jnp.einsum('bhqk,bhkd->bhqd', a, v_c))
    return jnp.concatenate(outs, axis=2).astype(q.dtype)


def mixer(u, w_mix_in, b_merge, conv_w, w_conv_out, w_attn_out, w_out):
    B, S, _ = u.shape
    proj = u @ w_mix_in
    idx = [CONV_WIDTH, 2 * CONV_WIDTH, 3 * CONV_WIDTH,
           3 * CONV_WIDTH + ATTN_WIDTH, 3 * CONV_WIDTH + 2 * ATTN_WIDTH,
           3 * CONV_WIDTH + 3 * ATTN_WIDTH, 3 * CONV_WIDTH + 3 * ATTN_WIDTH + D_MODEL]
    cb, cc, cx, q, k, v, ga, gb = jnp.split(proj, idx, axis=-1)
    ya = short_conv(cb, cc, cx, conv_w) @ w_conv_out
    def heads(t):
        return t.reshape(B, S, N_ATTN_HEADS, HEAD_DIM).transpose(0, 2, 1, 3)
    o = stick_breaking_attention(heads(q), heads(k), heads(v))
    o = o.transpose(0, 2, 1, 3).reshape(B, S, ATTN_WIDTH)
    yb = o @ w_attn_out
    merged = jax.nn.sigmoid(ga + b_merge[0]) * ya + jax.nn.sigmoid(gb + b_merge[1]) * yb
    return merged @ w_out


def setup_inputs(seed: int = 0) -> dict:
    key = jax.random.key(seed)
    ks = jax.random.split(key, 24)
    f32 = jnp.float32
    L, D = DEPTH, D_MODEL

    def nrm(k, shape, s):
        return jax.random.normal(k, shape, f32) * s

    return {
        "x": nrm(ks[0], (BATCH, SEQ, D), 1.0),
        "c": nrm(ks[1], (BATCH, D), 1.0),
        "w_ada": nrm(ks[2], (L, D, N_SUBLAYERS * N_MOD * D), 0.5 * D ** -0.5),
        "b_ada": nrm(ks[3], (L, N_SUBLAYERS * N_MOD * D), 0.02),
        "norm1_g": 1.0 + nrm(ks[4], (L, D), 0.02),
        "ffn1_w_gu": nrm(ks[5], (L, D, 2 * D_FF), D ** -0.5),
        "ffn1_w_down": nrm(ks[6], (L, D_FF, D), D_FF ** -0.5),
        "norm2_g": 1.0 + nrm(ks[7], (L, D), 0.02),
        "w_mix_in": nrm(ks[8], (L, D, MIX_IN_WIDTH), D ** -0.5),
        "b_merge": nrm(ks[9], (L, 2, D), 0.02),
        "conv_w": nrm(ks[10], (L, CONV_KSIZE, CONV_WIDTH), CONV_KSIZE ** -0.5),
        "w_conv_out": nrm(ks[11], (L, CONV_WIDTH, D), CONV_WIDTH ** -0.5),
        "w_attn_out": nrm(ks[12], (L, ATTN_WIDTH, D), ATTN_WIDTH ** -0.5),
        "w_out": nrm(ks[13], (L, D, D), D ** -0.5),
        "norm3_g": 1.0 + nrm(ks[14], (L, D), 0.02),
        "ffn2_w_gu": nrm(ks[15], (L, D, 2 * D_FF), D ** -0.5),
        "ffn2_w_down": nrm(ks[16], (L, D_FF, D), D_FF ** -0.5),
        "final_g": 1.0 + nrm(ks[17], (D,), 0.02),
    }


def reference(x, c, w_ada, b_ada, norm1_g, ffn1_w_gu, ffn1_w_down, norm2_g,
              w_mix_in, b_merge, conv_w, w_conv_out, w_attn_out, w_out,
              norm3_g, ffn2_w_gu, ffn2_w_down, final_g):
    B = x.shape[0]
    c_act = jax.nn.silu(c)
    h = x
    for l in range(DEPTH):
        mod = (c_act @ w_ada[l] + b_ada[l]).reshape(B, N_SUBLAYERS, N_MOD, D_MODEL)
        u = modulate(rmsnorm(h, norm1_g[l]), mod[:, 0, 0], mod[:, 0, 1])
        h = h + FFN_RES_WEIGHT * mod[:, 0, 2][:, None, :] * swiglu(u, ffn1_w_gu[l], ffn1_w_down[l])
        u = modulate(rmsnorm(h, norm2_g[l]), mod[:, 1, 0], mod[:, 1, 1])
        y = mixer(u, w_mix_in[l], b_merge[l], conv_w[l], w_conv_out[l], w_attn_out[l], w_out[l])
        h = h + mod[:, 1, 2][:, None, :] * y
        u = modulate(rmsnorm(h, norm3_g[l]), mod[:, 2, 0], mod[:, 2, 1])
        h = h + FFN_RES_WEIGHT * mod[:, 2, 2][:, None, :] * swiglu(u, ffn2_w_gu[l], ffn2_w_down[l])
    return rmsnorm(h, final_g)
```

```cpp
#include <hip/hip_runtime.h>
#include <cstdio>
#include <cstdint>
#include <cstring>

constexpr int NB = 4, SEQ = 4096, D = 1024, M = NB * SEQ, FF = 2816, NGU = 2 * FF, NMIX = 5120, CW = 512, AW = 512, NH = 8, HD = 64, NMOD = 9216;
constexpr int PCP = 1536, PQP = 1536, PGP = 2048;
constexpr float RMS_EPS = 1e-6f;
constexpr float QSCALE = 0.125f * 1.4426950408889634f;

#define MK_N_LAUNCHES 1
namespace pg8 {
#define PG8_LAS __attribute__((address_space(3)))
typedef unsigned short bf16_t;
typedef short bf16x8 __attribute__((ext_vector_type(8)));
typedef float f32x4 __attribute__((ext_vector_type(4)));
typedef unsigned u32x4 __attribute__((ext_vector_type(4)));
constexpr int BM = 256, BK = 64, HALF = 128, HTB = HALF * BK * 2  , STAGE_BYTES = 8 * HTB, NXCD = 8, WGM = 8;

__host__ __device__ __forceinline__ int lds_byte(int r, int c) { const int st = (r >> 4) * 2 + (c >> 5), rr = r & 15, cc = c & 31, ob = rr * 64 + cc * 2; return st * 1024 + (ob ^ (((ob >> 9) & 1) << 5)); }
__host__ __device__ __forceinline__ void stage_rc(int b, int& R, int& C) { const int st = b / 1024, sb = b % 1024, swz = sb ^ (((sb >> 9) & 1) << 5); R = (st >> 1) * 16 + swz / 64; C = (st & 1) * 32 + (swz % 64) / 2; }
__host__ __device__ __forceinline__ int perm32(int rho) { const int n = rho >> 4, i = rho & 15; return 8 * (i >> 2) + 4 * n + (i & 3); }
struct Unit { int pm, pn, pass; };
struct Gemm { const bf16_t* A; const bf16_t* Bt; int lda, ldb, K, kpass; };

struct StaticOrder {
    int nM, nN, nwg, G, c;
    __host__ __device__ void init(int M_, int N_, int G_, int c_) { nM = M_ / BM; nN = N_ / BM; nwg = nM * nN; G = G_; c = c_; }
    __host__ __device__ bool tile(int i, Unit& u) const {
        const long L = (long)i * G + c; if (L >= nwg) return false;
        int wgid = (int)L; { const int q = nwg / NXCD, r = nwg % NXCD, xcd = wgid % NXCD, off = wgid / NXCD; wgid = (xcd < r ? xcd * (q + 1) : r * (q + 1) + (xcd - r) * q) + off; }
        const int nig = WGM * nN, gid = wgid / nig, fm = gid * WGM, gsz = (nM - fm) < WGM ? (nM - fm) : WGM;
        u.pm = fm + ((wgid % nig) % gsz); u.pn = (wgid % nig) / gsz; u.pass = 0; return true;
    }
    __host__ __device__ bool next(int i, Unit& u) const { return tile(i, u); }
    __device__ __forceinline__ void a_ready(const Unit&) const {}
    __device__ __forceinline__ void done(const Unit&) const {}
};
struct TwoPassOrder : StaticOrder {
    __host__ __device__ bool next(int i, Unit& u) const { if (!tile(i >> 1, u)) return false; u.pass = i & 1; return true; }
};

__device__ __forceinline__ unsigned cvt_pk_bf16(float lo, float hi) { unsigned r; asm volatile("v_cvt_pk_bf16_f32 %0, %1, %2" : "=v"(r) : "v"(lo), "v"(hi)); return r; }
typedef unsigned u32x2 __attribute__((ext_vector_type(2)));
__device__ __forceinline__ float bflo(unsigned w) { return __builtin_bit_cast(float, w << 16); }
__device__ __forceinline__ float bfhi(unsigned w) { return __builtin_bit_cast(float, w & 0xffff0000u); }
__device__ __forceinline__ float sigmoid_f(float x) { return __builtin_amdgcn_rcpf(1.0f + __builtin_amdgcn_exp2f(x * -1.4426950408889634f)); }
__device__ __forceinline__ f32x4 sigmoid4(f32x4 x) { return (f32x4){sigmoid_f(x[0]), sigmoid_f(x[1]), sigmoid_f(x[2]), sigmoid_f(x[3])}; }

struct EpiSwiGLU {
    static constexpr bool PERM = true, AFTER_DRAIN = false;
    bf16_t* O; int ldc;
    __device__ __forceinline__ void operator()(const f32x4 (&acc)[2][2][4][2], const Unit& u, int wr, int wc, int fr, int fq) const {
        const int row0 = u.pm * BM + wr * 64 + fr, col0 = u.pn * HALF + wc * 32 + 8 * fq;
#pragma unroll
        for (int ai = 0; ai < 2; ++ai)
#pragma unroll
            for (int m = 0; m < 4; ++m) { bf16_t* rowp = O + (size_t)(row0 + ai * HALF + m * 16) * ldc + col0;
                const f32x4 g0 = acc[ai][0][m][0], g1 = acc[ai][0][m][1], u0 = acc[ai][1][m][0], u1 = acc[ai][1][m][1];
                const f32x4 v0 = g0 * sigmoid4(g0) * u0, v1 = g1 * sigmoid4(g1) * u1;
                u32x4 w; w.x = cvt_pk_bf16(v0[0], v0[1]); w.y = cvt_pk_bf16(v0[2], v0[3]); w.z = cvt_pk_bf16(v1[0], v1[1]); w.w = cvt_pk_bf16(v1[2], v1[3]);
                *(u32x4*)rowp = w; }
    }
};
struct EpiResid {
    static constexpr bool PERM = false, AFTER_DRAIN = false;
    const float* hin; float* out; const float* gate; int gate_bstride, rows_per_b; float fac;
    __device__ __forceinline__ void operator()(const f32x4 (&acc)[2][2][4][2], const Unit& u, int wr, int wc, int fr, int fq) const {
        const int row0 = u.pm * BM + wr * 64 + fr, col0 = u.pn * BM + wc * 32 + 4 * fq;
        const float* gv = gate + (size_t)((u.pm * BM) / rows_per_b) * gate_bstride + col0;
        f32x4 gt[2][2];
#pragma unroll
        for (int bj = 0; bj < 2; ++bj)
#pragma unroll
            for (int n = 0; n < 2; ++n) gt[bj][n] = *(const f32x4*)(gv + bj * HALF + n * 16) * fac;
#pragma unroll
        for (int ai = 0; ai < 2; ++ai)
#pragma unroll
            for (int m = 0; m < 4; ++m) { const size_t off = (size_t)(row0 + ai * HALF + m * 16) * D + col0;
#pragma unroll
                for (int bj = 0; bj < 2; ++bj)
#pragma unroll
                    for (int n = 0; n < 2; ++n) { const f32x4 h = *(const f32x4*)(hin + off + bj * HALF + n * 16); *(f32x4*)(out + off + bj * HALF + n * 16) = h + gt[bj][n] * acc[ai][bj][m][n]; } }
    }
};
struct EpiMix {
    static constexpr bool PERM = true, AFTER_DRAIN = false;
    bf16_t* PC; bf16_t* PQ; bf16_t* PG; float qscale;
    __device__ __forceinline__ void operator()(const f32x4 (&acc)[2][2][4][2], const Unit& u, int wr, int wc, int fr, int fq) const {
        bf16_t* base; int ldc, colt; float sc = 1.f;
        if (u.pn < 6) { base = PC; ldc = PCP; colt = u.pn * BM; }
        else if (u.pn < 12) { base = PQ; ldc = PQP; colt = (u.pn - 6) * BM; if (u.pn < 8) sc = qscale; }
        else { base = PG; ldc = PGP; colt = (u.pn - 12) * BM; }
        const int row0 = u.pm * BM + wr * 64 + fr, col0 = colt + wc * 32 + 8 * fq;
#pragma unroll
        for (int ai = 0; ai < 2; ++ai)
#pragma unroll
            for (int m = 0; m < 4; ++m) { bf16_t* rowp = base + (size_t)(row0 + ai * HALF + m * 16) * ldc + col0;
#pragma unroll
                for (int bj = 0; bj < 2; ++bj) { const f32x4 v0 = acc[ai][bj][m][0] * sc, v1 = acc[ai][bj][m][1] * sc;
                    u32x4 w; w.x = cvt_pk_bf16(v0[0], v0[1]); w.y = cvt_pk_bf16(v0[2], v0[3]); w.z = cvt_pk_bf16(v1[0], v1[1]); w.w = cvt_pk_bf16(v1[2], v1[3]);
                    *(u32x4*)(rowp + bj * HALF) = w; } }
    }
};
struct EpiMerge {
    static constexpr bool PERM = false, AFTER_DRAIN = false;
    float* stash; bf16_t* merged; const bf16_t* PG; const float* bmerge;
    __device__ __forceinline__ void operator()(const f32x4 (&acc)[2][2][4][2], const Unit& u, int wr, int wc, int fr, int fq) const {
        const int row0 = u.pm * BM + wr * 64 + fr, col0 = u.pn * BM + wc * 32 + 4 * fq;
        const int p = u.pass;
        f32x4 bm[2][2];
#pragma unroll
        for (int bj = 0; bj < 2; ++bj)
#pragma unroll
            for (int n = 0; n < 2; ++n) bm[bj][n] = *(const f32x4*)(bmerge + p * D + col0 + bj * HALF + n * 16);
#pragma unroll
        for (int ai = 0; ai < 2; ++ai)
#pragma unroll
            for (int m = 0; m < 4; ++m) { const size_t row = (size_t)(row0 + ai * HALF + m * 16);
#pragma unroll
                for (int bj = 0; bj < 2; ++bj)
#pragma unroll
                    for (int n = 0; n < 2; ++n) { const int c = col0 + bj * HALF + n * 16;
                        const u32x2 gw = *(const u32x2*)(PG + row * PGP + p * D + c);
                        const f32x4 gl = (f32x4){bflo(gw.x), bfhi(gw.x), bflo(gw.y), bfhi(gw.y)} + bm[bj][n];
                        const f32x4 v = sigmoid4(gl) * acc[ai][bj][m][n];
                        if (p == 0) *(f32x4*)(stash + row * D + c) = v;
                        else { const f32x4 s = *(const f32x4*)(stash + row * D + c) + v; u32x2 w; w.x = cvt_pk_bf16(s[0], s[1]); w.y = cvt_pk_bf16(s[2], s[3]); *(u32x2*)(merged + row * D + c) = w; } } }
    }
};

template <class Epi, class Sched, bool ALIGN_EPI = false, bool SP2 = false>
__device__ __forceinline__ void gemm_phase(PG8_LAS unsigned char* lds, const Gemm g, const Sched& S, const Epi& E) {
    const int tid = threadIdx.x, wid = __builtin_amdgcn_readfirstlane(tid >> 6), lane = tid & 63, wr = wid >> 2, wc = wid & 3, fr = lane & 15, fq = lane >> 4;
    const int K = g.K, nt = K / BK;
    unsigned voffA[2], voffB[2];
#pragma unroll
    for (int i = 0; i < 2; ++i) { int R, C; stage_rc(tid * 16 + i * 8192, R, C); const int Rb = Epi::PERM ? ((R & ~31) + perm32(R & 31)) : R;
        voffA[i] = (unsigned)(R * g.lda + C) * 2u; voffB[i] = (unsigned)(Rb * g.ldb + C) * 2u; }
    const size_t kstep = (size_t)(BK * 2);
    const size_t hstepA = (size_t)HALF * g.lda * 2, hstepB = (size_t)HALF * g.ldb * 2;
    const size_t tstepA = 2 * hstepA, tstepB = 2 * hstepB, pstep = (size_t)g.kpass * 2;
    const unsigned ldsw = (unsigned)wid * 1024u;
    const int aoff = lds_byte(wr * 64 + fr, fq * 8), boff = lds_byte(wc * 32 + fr, fq * 8);
#define PG8_SA(b, h) (((b) * 2 + (h)) * HTB)
#define PG8_SB(b, h) ((4 + (b) * 2 + (h)) * HTB)
#define PG8_STAGE(bufoff, gbase, voff) do { _Pragma("unroll") for (int _i = 0; _i < 2; ++_i) \
        __builtin_amdgcn_global_load_lds((const unsigned*)((const char*)(gbase) + (voff)[_i]), (PG8_LAS unsigned*)(lds + (bufoff) + ldsw + _i * 8192), 16, 0, 0); } while (0)
#define PG8_LDA(dst, b, h) do { _Pragma("unroll") for (int m = 0; m < 4; ++m) _Pragma("unroll") for (int k = 0; k < 2; ++k) dst[m][k] = *(const PG8_LAS bf16x8*)(lds + PG8_SA(b, h) + aoff + m * 2048 + k * 1024); } while (0)
#define PG8_LDB(dst, b, h) do { _Pragma("unroll") for (int n = 0; n < 2; ++n) _Pragma("unroll") for (int k = 0; k < 2; ++k) dst[n][k] = *(const PG8_LAS bf16x8*)(lds + PG8_SB(b, h) + boff + n * 2048 + k * 1024); } while (0)
#define PG8_MMA(ai, bj, At, Bt) do { __builtin_amdgcn_s_setprio(1); _Pragma("unroll") for (int m = 0; m < 4; ++m) _Pragma("unroll") for (int n = 0; n < 2; ++n) _Pragma("unroll") for (int k = 0; k < 2; ++k) \
        acc[ai][bj][m][n] = __builtin_amdgcn_mfma_f32_16x16x32_bf16(Bt[n][k], At[m][k], acc[ai][bj][m][n], 0, 0, 0); __builtin_amdgcn_s_setprio(0); } while (0)
#define PG8_WAIT_V(n) asm volatile("s_waitcnt vmcnt(" #n ")" ::: "memory")
#define PG8_WAIT_L(n) asm volatile("s_waitcnt lgkmcnt(" #n ")" ::: "memory")
#define PG8_BAR __builtin_amdgcn_s_barrier()
#define PG8_SCHED __builtin_amdgcn_sched_barrier(0)
    Unit cur, nxt; int ui = 0;
    if (!S.next(0, cur)) return;
    f32x4 acc[2][2][4][2];
#pragma unroll
    for (int a = 0; a < 2; ++a)
#pragma unroll
        for (int b = 0; b < 2; ++b)
#pragma unroll
            for (int m = 0; m < 4; ++m)
#pragma unroll
                for (int n = 0; n < 2; ++n) acc[a][b][m][n] = (f32x4){0.f, 0.f, 0.f, 0.f};
    bf16x8 At[4][2], B0[2][2], B1[2][2];
    const char* cA = (const char*)g.A + (size_t)cur.pm * tstepA + (size_t)cur.pass * pstep; const char* cB = (const char*)g.Bt + (size_t)cur.pn * tstepB + (size_t)cur.pass * pstep;
    S.a_ready(cur);
    if constexpr (SP2) {
        PG8_STAGE(PG8_SB(0, 0), cB, voffB); PG8_STAGE(PG8_SB(0, 1), cB + hstepB, voffB); PG8_STAGE(PG8_SA(0, 0), cA, voffA); PG8_STAGE(PG8_SA(0, 1), cA + hstepA, voffA);
        if (wr == 1) PG8_BAR;
        PG8_WAIT_V(2); PG8_BAR;
        PG8_STAGE(PG8_SB(1, 0), cB + kstep, voffB); PG8_STAGE(PG8_SA(1, 0), cA + kstep, voffA); PG8_STAGE(PG8_SB(1, 1), cB + hstepB + kstep, voffB);
        PG8_WAIT_V(6); PG8_BAR;
    } else {
        PG8_STAGE(PG8_SB(0, 0), cB, voffB); PG8_STAGE(PG8_SA(0, 0), cA, voffA); PG8_STAGE(PG8_SB(0, 1), cB + hstepB, voffB); PG8_STAGE(PG8_SA(0, 1), cA + hstepA, voffA);
        if (wr == 1) PG8_BAR;
        PG8_WAIT_V(4); PG8_BAR;
        PG8_STAGE(PG8_SB(1, 0), cB + kstep, voffB); PG8_STAGE(PG8_SA(1, 0), cA + kstep, voffA); PG8_STAGE(PG8_SB(1, 1), cB + hstepB + kstep, voffB);
        PG8_WAIT_V(6); PG8_BAR;
    }
    for (;;) {
        const bool has_next = S.next(ui + 1, nxt);
        const char* nA = has_next ? (const char*)g.A + (size_t)nxt.pm * tstepA + (size_t)nxt.pass * pstep : cA; const char* nB = has_next ? (const char*)g.Bt + (size_t)nxt.pn * tstepB + (size_t)nxt.pass * pstep : cB;
        for (int t = 0; t < nt; t += 2) {
            const bool last = (t == nt - 2);
            const char* a1 = cA + (size_t)(t + 1) * kstep;
            const char* a2 = last ? nA : cA + (size_t)(t + 2) * kstep; const char* b2 = last ? nB : cB + (size_t)(t + 2) * kstep;
            const char* a3 = a2 + kstep; const char* b3 = b2 + kstep;
            if (last && has_next) S.a_ready(nxt);
            if constexpr (SP2) {
            PG8_LDB(B0, 0, 0); PG8_LDB(B1, 0, 1); PG8_SCHED; PG8_LDA(At, 0, 0); PG8_STAGE(PG8_SA(1, 1), a1 + hstepA, voffA);
            PG8_WAIT_V(8); PG8_WAIT_L(0); PG8_BAR; PG8_MMA(0, 0, At, B0); PG8_MMA(0, 1, At, B1); PG8_BAR; PG8_SCHED;
            PG8_LDA(At, 0, 1); PG8_STAGE(PG8_SB(0, 0), b2, voffB); PG8_STAGE(PG8_SB(0, 1), b2 + hstepB, voffB); PG8_STAGE(PG8_SA(0, 0), a2, voffA);
            PG8_WAIT_V(8); PG8_WAIT_L(0); PG8_BAR; PG8_MMA(1, 0, At, B0); PG8_MMA(1, 1, At, B1); PG8_BAR; PG8_SCHED;
            PG8_LDB(B0, 1, 0); PG8_LDB(B1, 1, 1); PG8_SCHED; PG8_LDA(At, 1, 0); PG8_STAGE(PG8_SA(0, 1), a2 + hstepA, voffA);
            PG8_WAIT_V(8); PG8_WAIT_L(0); PG8_BAR; PG8_MMA(0, 0, At, B0); PG8_MMA(0, 1, At, B1); PG8_BAR; PG8_SCHED;
            PG8_LDA(At, 1, 1); PG8_STAGE(PG8_SB(1, 0), b3, voffB); PG8_STAGE(PG8_SB(1, 1), b3 + hstepB, voffB); PG8_STAGE(PG8_SA(1, 0), a3, voffA);
            PG8_WAIT_V(8); PG8_WAIT_L(0); PG8_BAR; PG8_MMA(1, 0, At, B0); PG8_MMA(1, 1, At, B1); PG8_BAR; PG8_SCHED;
            } else {
            PG8_LDB(B0, 0, 0); PG8_SCHED; PG8_LDA(At, 0, 0); PG8_STAGE(PG8_SA(1, 1), a1 + hstepA, voffA);
            PG8_WAIT_L(8); PG8_BAR; PG8_WAIT_L(0); PG8_MMA(0, 0, At, B0); PG8_BAR; PG8_SCHED;
            PG8_LDB(B1, 0, 1); PG8_STAGE(PG8_SB(0, 0), b2, voffB);
            PG8_BAR; PG8_WAIT_L(0); PG8_MMA(0, 1, At, B1); PG8_BAR;
            PG8_LDA(At, 0, 1); PG8_STAGE(PG8_SA(0, 0), a2, voffA);
            PG8_BAR; PG8_WAIT_L(0); PG8_MMA(1, 0, At, B0); PG8_BAR; PG8_SCHED;
            PG8_STAGE(PG8_SB(0, 1), b2 + hstepB, voffB);
            PG8_WAIT_V(6); PG8_BAR; PG8_MMA(1, 1, At, B1); PG8_BAR;
            PG8_LDB(B0, 1, 0); PG8_SCHED; PG8_LDA(At, 1, 0); PG8_STAGE(PG8_SA(0, 1), a2 + hstepA, voffA);
            PG8_WAIT_L(8); PG8_BAR; PG8_WAIT_L(0); PG8_MMA(0, 0, At, B0); PG8_BAR; PG8_SCHED;
            PG8_LDB(B1, 1, 1); PG8_STAGE(PG8_SB(1, 0), b3, voffB);
            PG8_BAR; PG8_WAIT_L(0); PG8_MMA(0, 1, At, B1); PG8_BAR;
            PG8_LDA(At, 1, 1); PG8_STAGE(PG8_SA(1, 0), a3, voffA);
            PG8_BAR; PG8_WAIT_L(0); PG8_MMA(1, 0, At, B0); PG8_BAR; PG8_SCHED;
            PG8_STAGE(PG8_SB(1, 1), b3 + hstepB, voffB);
            PG8_WAIT_V(6); PG8_BAR; PG8_MMA(1, 1, At, B1); PG8_BAR;
            }
        }
        if constexpr (ALIGN_EPI) { if (wr == 0) PG8_BAR; }
        if constexpr (!Epi::AFTER_DRAIN) { E(acc, cur, wr, wc, fr, fq); S.done(cur); }
        if (!has_next) break;
#pragma unroll
        for (int a = 0; a < 2; ++a)
#pragma unroll
            for (int b = 0; b < 2; ++b)
#pragma unroll
                for (int m = 0; m < 4; ++m)
#pragma unroll
                    for (int n = 0; n < 2; ++n) acc[a][b][m][n] = (f32x4){0.f, 0.f, 0.f, 0.f};
        cur = nxt; cA = nA; cB = nB; ++ui;
        if constexpr (ALIGN_EPI) { if (wr == 1) PG8_BAR; }
    }
    PG8_WAIT_V(0);
    if constexpr (!ALIGN_EPI) { if (wr == 0) PG8_BAR; }
    PG8_BAR;
    if constexpr (Epi::AFTER_DRAIN) { E.fused(acc, cur, wr, wc, fr, fq, lds, wid, lane); S.done(cur); }
#undef PG8_SA
#undef PG8_SB
#undef PG8_STAGE
#undef PG8_LDA
#undef PG8_LDB
#undef PG8_MMA
#undef PG8_WAIT_V
#undef PG8_WAIT_L
#undef PG8_BAR
#undef PG8_SCHED
}
}

namespace sba {
using bf16x8 = __attribute__((ext_vector_type(8))) short;
using s16x4 = __attribute__((ext_vector_type(4))) short;
using f32x16 = __attribute__((ext_vector_type(16))) float;
using u32x4 = __attribute__((ext_vector_type(4))) unsigned;
typedef unsigned short bf16;
constexpr int KVBLK = 64, QB = 256, SLOTB = 8192;
constexpr int LDS_K = 0, LDS_V = 2 * SLOTB, LDS_FLAG = 4 * SLOTB, LDS_OST = LDS_FLAG + 256, LDS_BYTES = LDS_OST + 8 * 4096;
constexpr float THR2 = 152.0f;
#define SBAR() __builtin_amdgcn_sched_barrier(0)
__device__ __forceinline__ int crow(int r, int hi) { return (r & 3) + 8 * (r >> 2) + 4 * hi; }
__device__ __forceinline__ void glds16(const void* gsrc, unsigned lds_dst) { unsigned keep;
  asm volatile("s_mov_b32 %0, m0\n\ts_mov_b32 m0, %2\n\ts_nop 0\n\tglobal_load_lds_dwordx4 %1, off\n\ts_mov_b32 m0, %0" : "=&s"(keep) : "v"(gsrc), "s"(lds_dst) : "memory"); }
typedef float f32x2_t __attribute__((ext_vector_type(2))); typedef __bf16 bf16x2_t __attribute__((ext_vector_type(2)));
__device__ __forceinline__ unsigned cvtpk_s(float lo, float hi) { f32x2_t v = {lo, hi}; bf16x2_t b = __builtin_convertvector(v, bf16x2_t); return __builtin_bit_cast(unsigned, b); }
#define WAIT_BAR(N) asm volatile("s_waitcnt vmcnt(" #N ") lgkmcnt(0)\n\ts_barrier" ::: "memory")
typedef __attribute__((address_space(3))) char* lds_ptr; typedef __attribute__((address_space(3))) const char* lds_cptr;
__device__ __forceinline__ void qkt(f32x16& p0, f32x16& p1, lds_cptr Kslot, const bf16x8* qr, int r32, int hi) {
  lds_cptr kb = Kslot + hi * 1024 + r32 * 16; const f32x16 z = f32x16{};
#pragma unroll
  for (int d0 = 0; d0 < 4; ++d0) {
    const bf16x8 b0 = *(const __attribute__((address_space(3))) bf16x8*)(kb + d0 * 2048);
    const bf16x8 b1 = *(const __attribute__((address_space(3))) bf16x8*)(kb + d0 * 2048 + 512);
    if (d0 == 0) { p0 = __builtin_amdgcn_mfma_f32_32x32x16_bf16(b0, qr[0], z, 0, 0, 0); p1 = __builtin_amdgcn_mfma_f32_32x32x16_bf16(b1, qr[0], z, 0, 0, 0); }
    else { p0 = __builtin_amdgcn_mfma_f32_32x32x16_bf16(b0, qr[d0], p0, 0, 0, 0); p1 = __builtin_amdgcn_mfma_f32_32x32x16_bf16(b1, qr[d0], p1, 0, 0, 0); } }
}
__device__ __forceinline__ void pv(f32x16* o, int vb, bf16x8 pa0, bf16x8 pa1, bf16x8 pa2, bf16x8 pa3) {
#pragma unroll
  for (int d0 = 0; d0 < 2; ++d0) { s16x4 lo[4], hi[4];
#pragma unroll
    for (int ks = 0; ks < 4; ++ks) {
      asm volatile("ds_read_b64_tr_b16 %0,%1 offset:%c2" : "=&v"(lo[ks]) : "v"(vb), "i"(d0 * 4096 + ks * 1024) : "memory");
      asm volatile("ds_read_b64_tr_b16 %0,%1 offset:%c2" : "=&v"(hi[ks]) : "v"(vb), "i"(d0 * 4096 + ks * 1024 + 512) : "memory"); }
    asm volatile("s_waitcnt lgkmcnt(0)" ::: "memory"); SBAR();
#define PK(k) (bf16x8){lo[k][0], lo[k][1], lo[k][2], lo[k][3], hi[k][0], hi[k][1], hi[k][2], hi[k][3]}
    o[d0] = __builtin_amdgcn_mfma_f32_32x32x16_bf16(pa0, PK(0), o[d0], 0, 0, 0);
    o[d0] = __builtin_amdgcn_mfma_f32_32x32x16_bf16(pa1, PK(1), o[d0], 0, 0, 0);
    o[d0] = __builtin_amdgcn_mfma_f32_32x32x16_bf16(pa2, PK(2), o[d0], 0, 0, 0);
    o[d0] = __builtin_amdgcn_mfma_f32_32x32x16_bf16(pa3, PK(3), o[d0], 0, 0, 0);
#undef PK
  }
}
__device__ __forceinline__ float softplus2(float z) {
  return __builtin_fmaxf(z, 0.f) + __builtin_amdgcn_logf(1.0f + __builtin_amdgcn_exp2f(-__builtin_fabsf(z)));
}
__device__ __forceinline__ void sb_unit(int b, int h, int qb, const bf16* __restrict__ QKV, bf16* O, int ocol0, lds_ptr shm) {
  const int tid = threadIdx.x, lane = tid & 63, r32 = lane & 31, hi = lane >> 5; const int wid = __builtin_amdgcn_readfirstlane(tid >> 6);
  const long rowbase = (long)b * SEQ; const int q0 = qb * QB;
  const bf16* Qw = QKV + (rowbase + q0 + wid * 32) * PQP + h * HD;
  const bf16* Kh = QKV + rowbase * PQP + 512 + h * HD; const bf16* Vh = Kh + 512;
  const unsigned lds0 = (unsigned)(uintptr_t)shm;
  const bf16* ksrc = Kh + (long)lane * PQP + wid * 8;
  const bf16* vsrc = Vh + (long)(16 * (wid & 3) + (lane >> 2)) * PQP + (wid >> 2) * 32 + (lane & 3) * 8;
  const unsigned kdst = lds0 + LDS_K + wid * 1024, vdst = lds0 + LDS_V + wid * 1024;
#define DMA_K(t, slot) glds16(ksrc + (long)(t) * KVBLK * PQP, (unsigned)__builtin_amdgcn_readfirstlane(kdst + (slot)))
#define DMA_V(t, slot) glds16(vsrc + (long)(t) * KVBLK * PQP, (unsigned)__builtin_amdgcn_readfirstlane(vdst + (slot)))
  const int vb0 = (int)(lds0 + LDS_V) + ((lane >> 4) & 1) * 32 + (lane & 3) * 8 + (4 * hi + ((lane & 15) >> 2)) * 64;
  __attribute__((address_space(3))) unsigned* flags = (__attribute__((address_space(3))) unsigned*)(shm + LDS_FLAG);
  const int NT = (q0 + QB) / KVBLK;
  const int jd = q0 / KVBLK + (wid >> 1);
  DMA_K(NT - 1, 0); DMA_V(NT - 1, 0);
  bf16x8 qr[4];
#pragma unroll
  for (int d0 = 0; d0 < 4; ++d0) qr[d0] = *reinterpret_cast<const bf16x8*>(&Qw[(long)r32 * PQP + d0 * 16 + hi * 8]);
  f32x16 o[2]; o[0] = f32x16{}; o[1] = f32x16{};
  float R2 = 0.f; bool wdone = false; int slot = 0;
  const int qin = 32 * (wid & 1) + r32;
  for (int j = NT - 1; j >= 0; --j) {
    if (j > 0) { DMA_K(j - 1, (slot ^ 1) * SLOTB); DMA_V(j - 1, (slot ^ 1) * SLOTB); WAIT_BAR(2); }
    else { WAIT_BAR(0); }
    if (j <= jd && !wdone) {
      f32x16 p0, p1;
      qkt(p0, p1, shm + LDS_K + slot * SLOTB, qr, r32, hi);
      if (j == jd) {
#pragma unroll
        for (int r = 0; r < 16; ++r) { const int kv = crow(r, hi); if (kv >= qin) p0[r] = -INFINITY; if (kv + 32 >= qin) p1[r] = -INFINITY; }
      }
      f32x16 w0, w1;
#pragma unroll
      for (int g = 0; g < 4; ++g) {
        w0[4 * g + 3] = softplus2(p0[4 * g + 3]); w0[4 * g + 2] = softplus2(p0[4 * g + 2]) + w0[4 * g + 3]; w0[4 * g + 1] = softplus2(p0[4 * g + 1]) + w0[4 * g + 2]; w0[4 * g] = softplus2(p0[4 * g]) + w0[4 * g + 1];
        w1[4 * g + 3] = softplus2(p1[4 * g + 3]); w1[4 * g + 2] = softplus2(p1[4 * g + 2]) + w1[4 * g + 3]; w1[4 * g + 1] = softplus2(p1[4 * g + 1]) + w1[4 * g + 2]; w1[4 * g] = softplus2(p1[4 * g]) + w1[4 * g + 1];
      }
      float OS[9]; OS[8] = 0.f;
#pragma unroll
      for (int gg = 7; gg >= 0; --gg) OS[gg] = OS[gg + 1] + (gg < 4 ? w0[4 * gg] : w1[4 * (gg - 4)]);
      float base[8];
#pragma unroll
      for (int gg = 0; gg < 8; ++gg) {
        auto rr = __builtin_amdgcn_permlane32_swap(__float_as_uint(OS[gg]), __float_as_uint(OS[gg + 1]), false, false);
        const float X = __uint_as_float(hi ? rr[0] : rr[1]);
        base[gg] = R2 + OS[gg + 1] + X;
      }
      { auto rr = __builtin_amdgcn_permlane32_swap(__float_as_uint(OS[0]), __float_as_uint(OS[0]), false, false); R2 += __uint_as_float(rr[0]) + __uint_as_float(rr[1]); }
#pragma unroll
      for (int r = 0; r < 16; ++r) { p0[r] = __builtin_amdgcn_exp2f(p0[r] - base[r >> 2] - w0[r]); p1[r] = __builtin_amdgcn_exp2f(p1[r] - base[4 + (r >> 2)] - w1[r]); }
      u32x4 pw0, pw1, pw2, pw3;
      pw0 = (u32x4){cvtpk_s(p0[0], p0[1]), cvtpk_s(p0[2], p0[3]), cvtpk_s(p0[4], p0[5]), cvtpk_s(p0[6], p0[7])};
      pw1 = (u32x4){cvtpk_s(p0[8], p0[9]), cvtpk_s(p0[10], p0[11]), cvtpk_s(p0[12], p0[13]), cvtpk_s(p0[14], p0[15])};
      pw2 = (u32x4){cvtpk_s(p1[0], p1[1]), cvtpk_s(p1[2], p1[3]), cvtpk_s(p1[4], p1[5]), cvtpk_s(p1[6], p1[7])};
      pw3 = (u32x4){cvtpk_s(p1[8], p1[9]), cvtpk_s(p1[10], p1[11]), cvtpk_s(p1[12], p1[13]), cvtpk_s(p1[14], p1[15])};
      SBAR();
      pv(o, vb0 + slot * SLOTB, __builtin_bit_cast(bf16x8, pw0), __builtin_bit_cast(bf16x8, pw1), __builtin_bit_cast(bf16x8, pw2), __builtin_bit_cast(bf16x8, pw3));
      wdone = __all(R2 > THR2);
    }
    if (lane == 0) flags[wid] = wdone ? 1u : 0u;
    WAIT_BAR(2);
    unsigned nd = 0;
#pragma unroll
    for (int w = 0; w < 8; ++w) nd += flags[w];
    if (__builtin_amdgcn_readfirstlane(nd) == 8u) break;
    slot ^= 1;
  }
  bf16* Ow = O + (rowbase + q0 + wid * 32) * D + ocol0 + h * HD;
  { __attribute__((address_space(3))) bf16* stg = (__attribute__((address_space(3))) bf16*)(shm + LDS_OST) + wid * 2048;
#pragma unroll
    for (int r = 0; r < 16; ++r) { const int orow = crow(r, hi);
#pragma unroll
      for (int d0 = 0; d0 < 2; ++d0) stg[orow * 64 + d0 * 32 + r32] = (bf16)(cvtpk_s(o[d0][r], 0.f) & 0xffffu); }
    asm volatile("s_waitcnt lgkmcnt(0)" ::: "memory");
#pragma unroll
    for (int i = 0; i < 4; ++i) { const int row = i * 8 + (lane >> 3), ch = lane & 7; const u32x4 v = *(const __attribute__((address_space(3))) u32x4*)(stg + row * 64 + ch * 8); *(u32x4*)(Ow + (long)row * D + ch * 8) = v; } }
  asm volatile("s_waitcnt vmcnt(0) lgkmcnt(0)\n\ts_barrier" ::: "memory");
#undef DMA_K
#undef DMA_V
}
#undef SBAR
#undef WAIT_BAR
}

constexpr int NWAVES = 8;
constexpr int N_PHASES = 13;
#ifndef MK_N_LAUNCHES
#define MK_N_LAUNCHES 1
#endif
#ifndef MK_NAIVE_MASK
#define MK_NAIVE_MASK 0u
#endif
constexpr int N_LAUNCHES = MK_N_LAUNCHES;

constexpr size_t MiB = 1u << 20;
constexpr size_t WS_CTL = 0, CTL_ZERO_BYTES = 1 * MiB;
constexpr size_t WS_MOD = 1 * MiB;
constexpr size_t WS_WGU1 = 2 * MiB, WS_WGU2 = 13 * MiB, WS_WD1 = 24 * MiB, WS_WD2 = 30 * MiB, WS_WMIX = 36 * MiB, WS_WCA = 46 * MiB, WS_WO = 48 * MiB;
constexpr size_t WS_XN = 50 * MiB;
constexpr size_t WS_CVO = 50 * MiB;
constexpr size_t WS_ACT = 82 * MiB;
constexpr size_t WS_PQ = 82 * MiB, WS_PC = 130 * MiB, WS_PG = 178 * MiB;
constexpr size_t WS_STASH = 82 * MiB, WS_MERGED = 146 * MiB;
constexpr size_t WS_END = 242 * MiB;
static_assert(WS_WO + (size_t)D * D * 2 <= WS_XN && WS_XN + (size_t)M * D * 2 <= WS_ACT && WS_ACT + (size_t)M * FF * 2 <= WS_END, "d_ws map");
static_assert(WS_PQ + (size_t)M * PQP * 2 <= WS_PC && WS_PC + (size_t)M * PCP * 2 <= WS_PG && WS_PG + (size_t)M * PGP * 2 <= WS_END, "d_ws map (mixer)");
static_assert(WS_STASH + (size_t)M * D * 4 <= WS_MERGED && WS_MERGED + (size_t)M * D * 2 <= WS_PG, "d_ws map (merge)");
constexpr int CW_TMO = 0, CW_CODE = 1;
constexpr int CW_BAR = 4096;

constexpr int RING_OFF = 0, RING_BYTES = 131072;
constexpr int LDSCTL_OFF = RING_BYTES, MISC_OFF = LDSCTL_OFF + 320;
constexpr int LDS_BYTES = 147456;
static_assert(MISC_OFF + 128 <= LDS_BYTES && sba::LDS_BYTES <= RING_BYTES, "LDS map");

#define GAS __attribute__((address_space(1)))
#define LAS __attribute__((address_space(3)))
typedef unsigned short bf16;
typedef unsigned v4u __attribute__((ext_vector_type(4)));
typedef unsigned v2u __attribute__((ext_vector_type(2)));
typedef float f32x4 __attribute__((ext_vector_type(4)));
typedef GAS unsigned gu32;
#define RLX_AGENT __ATOMIC_RELAXED, __HIP_MEMORY_SCOPE_AGENT
#define LDS_WAIT() asm volatile("s_waitcnt lgkmcnt(0)" ::: "memory")
#define VM_WAIT() asm volatile("s_waitcnt vmcnt(0)" ::: "memory")
__device__ __forceinline__ unsigned f2bf(float f) { unsigned u = __builtin_bit_cast(unsigned, f); return (u + 0x7fffu + ((u >> 16) & 1u)) >> 16; }
__device__ __forceinline__ unsigned pk2(float lo, float hi) { return f2bf(lo) | (f2bf(hi) << 16); }
__device__ __forceinline__ float bf2f(unsigned h) { return __builtin_bit_cast(float, h << 16); }

#define XB_TMO      128
#define XB_XCNT(j)  (256  + 64 * (j))
#define XB_XSUB(j)  (1280 + 64 * (j))
#define XB_XGEN(j)  (2304 + 64 * (j))
#define XB_TOP      3328
#define XB_TOPGEN   3392
#define XCD_BAR_WORDS 3456
#define XB_SPIN_CAP (1u << 18)

__device__ __forceinline__ unsigned xb_ld(unsigned* p)              { return __hip_atomic_load(p, __ATOMIC_RELAXED, __HIP_MEMORY_SCOPE_AGENT); }
__device__ __forceinline__ unsigned xb_add(unsigned* p, unsigned v) { return __hip_atomic_fetch_add(p, v, __ATOMIC_RELAXED, __HIP_MEMORY_SCOPE_AGENT); }
__device__ __forceinline__ unsigned xb_xcc_id() { return (unsigned)__builtin_amdgcn_s_getreg((3 << 11) | 20) & 0xFu; }
#define XB_SPIN(cond, bar) do { unsigned _sp = 0; while (cond) { __builtin_amdgcn_s_sleep(1); \
    if ((++_sp & 255u) == 0u) { if (xb_ld(&(bar)[XB_TMO])) break; if (_sp > XB_SPIN_CAP) { atomicAdd(&(bar)[XB_TMO], 1u); break; } } } } while (0)

struct XcdBarrier {
    unsigned* bar; unsigned x;
    volatile LAS unsigned* st;
};

__device__ __forceinline__ XcdBarrier xcd_barrier_post(unsigned* bar, volatile LAS unsigned* st) {
    XcdBarrier b; b.bar = bar; b.x = xb_xcc_id(); b.st = st;
    if (threadIdx.x == 0) (void)xb_add(&bar[XB_XCNT(b.x)], 1u);
    return b;
}
__device__ __forceinline__ void xcd_barrier_complete(unsigned* bar, unsigned x, unsigned& nloc, unsigned& nx) {
    const unsigned G = gridDim.x * gridDim.y * gridDim.z;
    unsigned sum, cnt, mine, sp = 0u;
    for (;;) {
        sum = 0u; cnt = 0u; mine = 0u;
#pragma unroll
        for (unsigned j = 0; j < 16; ++j) { const unsigned c = xb_ld(&bar[XB_XCNT(j)]); sum += c; cnt += (c > 0u) ? 1u : 0u; mine = (j == x) ? c : mine; }
        if (sum == G) break;
        __builtin_amdgcn_s_sleep(1);
        if ((++sp & 255u) == 0u) { if (xb_ld(&bar[XB_TMO])) break; if (sp > XB_SPIN_CAP) { atomicAdd(&bar[XB_TMO], 1u); break; } }
    }
    nloc = mine > 0u ? mine : 1u; nx = cnt > 0u ? cnt : 1u;
}

__device__ __forceinline__ void xcd_barrier(const XcdBarrier& b) {
    asm volatile("s_waitcnt vmcnt(0)" ::: "memory");
    __syncthreads();
    if (threadIdx.x == 0) {
        unsigned* bar = b.bar;
        __builtin_amdgcn_s_waitcnt(0);
        unsigned nloc = b.st[0], nx = b.st[1];
        if (nloc == 0u) { xcd_barrier_complete(bar, b.x, nloc, nx); b.st[0] = nloc; b.st[1] = nx; }
        const unsigned old = xb_add(&bar[XB_XSUB(b.x)], 1u);
        const unsigned gen = old / nloc;
        if (old + 1u == (gen + 1u) * nloc) {
            __builtin_amdgcn_fence(__ATOMIC_RELEASE, "agent");
            asm volatile("s_waitcnt vmcnt(0)" ::: "memory");
            const unsigned og = xb_add(&bar[XB_TOP], 1u);
            const unsigned tg = og / nx;
            if (og + 1u == (tg + 1u) * nx) xb_add(&bar[XB_TOPGEN], 1u);
            else XB_SPIN(xb_ld(&bar[XB_TOPGEN]) == tg, bar);
            __builtin_amdgcn_fence(__ATOMIC_ACQUIRE, "agent");
            xb_add(&bar[XB_XGEN(b.x)], 1u);
            asm volatile("s_waitcnt vmcnt(0)" ::: "memory");
        } else {
            XB_SPIN(xb_ld(&bar[XB_XGEN(b.x)]) == gen, bar);
            __builtin_amdgcn_fence(__ATOMIC_ACQUIRE, "agent");
            asm volatile("s_waitcnt vmcnt(0)" ::: "memory");
        }
    }
    __syncthreads();
}
struct Frame {
    LAS unsigned char* lds;
    volatile LAS unsigned* MISC;
    gu32* ctl;
    int tid, lane, wave;
    int vcu, G;
};
__device__ __forceinline__ float wave_sum(float v) {
#pragma unroll
    for (int o = 1; o < 64; o <<= 1) v += __shfl_xor(v, o);
    return v;
}
__device__ __forceinline__ float silu_f(float x) { return x * pg8::sigmoid_f(x); }

__device__ __forceinline__ void p0_transpose_item(const float* W, int K, int N, bf16* WT, int ldk, int koff, int mode, LAS float* scr, int item, int lane) {
    const int nblk = N / 32, kb = item / nblk, nb = item % nblk, k0 = 64 * kb, n0 = 32 * nb;
#pragma unroll 8
    for (int i = 0; i < 32; ++i) { const int kk = 2 * i + (lane >> 5); scr[kk * 33 + (lane & 31)] = W[(size_t)(k0 + kk) * N + n0 + (lane & 31)]; }
    LDS_WAIT(); asm volatile("" ::: "memory");
    int r0 = n0; if (mode == 1) { const int up = n0 >= FF ? 1 : 0, j = n0 - up * FF; r0 = 256 * (j >> 7) + 128 * up + (j & 127); }
    const int c = lane & 7;
#pragma unroll
    for (int j = 0; j < 4; ++j) { const int n = (lane >> 3) + 8 * j; const LAS float* s = scr + (8 * c) * 33 + n;
        v4u o; o.x = pk2(s[0 * 33], s[1 * 33]); o.y = pk2(s[2 * 33], s[3 * 33]); o.z = pk2(s[4 * 33], s[5 * 33]); o.w = pk2(s[6 * 33], s[7 * 33]);
        *(GAS v4u*)(WT + (size_t)(r0 + n) * ldk + koff + k0 + 8 * c) = o; }
    LDS_WAIT(); asm volatile("" ::: "memory");
}
__device__ __forceinline__ void p0_mod_item(Frame& F, const LAS float* cact, LAS float* red, const float* w_ada, const float* b_ada, float* mod, int it) {
    const int n = 64 * it + F.lane, k0 = F.wave * 128;
    float a0 = 0.f, a1 = 0.f, a2 = 0.f, a3 = 0.f;
#pragma unroll 8
    for (int k = 0; k < 128; ++k) { const float w = w_ada[(size_t)(k0 + k) * NMOD + n];
        a0 += cact[0 * D + k0 + k] * w; a1 += cact[1 * D + k0 + k] * w; a2 += cact[2 * D + k0 + k] * w; a3 += cact[3 * D + k0 + k] * w; }
    red[(F.wave * 4 + 0) * 64 + F.lane] = a0; red[(F.wave * 4 + 1) * 64 + F.lane] = a1; red[(F.wave * 4 + 2) * 64 + F.lane] = a2; red[(F.wave * 4 + 3) * 64 + F.lane] = a3;
    __syncthreads();
    if (F.tid < 256) { const int b = F.tid >> 6, l = F.tid & 63; float s = b_ada[64 * it + l];
#pragma unroll
        for (int w = 0; w < 8; ++w) s += red[(w * 4 + b) * 64 + l];
        mod[b * NMOD + 64 * it + l] = s; }
    __syncthreads();
}
__device__ __forceinline__ void rmsmod_row(const float* hrow, const float* g, const float* sc, const float* sh, bf16* orow, int lane) {
    const GAS f32x4* xr = (const GAS f32x4*)hrow + lane;
    f32x4 v[4]; float s = 0.f;
#pragma unroll
    for (int j = 0; j < 4; ++j) { v[j] = xr[64 * j]; s += (v[j].x * v[j].x + v[j].y * v[j].y) + (v[j].z * v[j].z + v[j].w * v[j].w); }
    const float inv = 1.0f / sqrtf(wave_sum(s) * (1.f / D) + RMS_EPS);
    GAS v2u* o8 = (GAS v2u*)orow + lane;
#pragma unroll
    for (int j = 0; j < 4; ++j) { const int col = 4 * lane + 256 * j;
        const f32x4 gg = *(const f32x4*)(g + col), sv = *(const f32x4*)(sc + col), hv = *(const f32x4*)(sh + col);
        const f32x4 r = ((v[j] * inv) * gg) * (sv + 1.0f) + hv;
        v2u w; w.x = pk2(r.x, r.y); w.y = pk2(r.z, r.w); o8[64 * j] = w; }
}
__device__ __forceinline__ void rmsmod_phase(Frame& F, const float* h, const float* g, const float* mod, int sub, bf16* XN) {
    const int gw = F.vcu * NWAVES + F.wave, NGW = F.G * NWAVES;
    for (int m = gw; m < M; m += NGW) { const float* mb = mod + (size_t)(m / SEQ) * NMOD + (sub * 3) * D;
        rmsmod_row(h + (size_t)m * D, g, mb + D, mb, XN + (size_t)m * D, F.lane); }
}
__device__ __forceinline__ void final_phase(Frame& F, const float* h, const float* g, float* out) {
    const int gw = F.vcu * NWAVES + F.wave, NGW = F.G * NWAVES;
    for (int m = gw; m < M; m += NGW) {
        const GAS f32x4* xr = (const GAS f32x4*)(h + (size_t)m * D) + F.lane; GAS f32x4* o = (GAS f32x4*)(out + (size_t)m * D) + F.lane;
        f32x4 v[4]; float s = 0.f;
#pragma unroll
        for (int j = 0; j < 4; ++j) { v[j] = xr[64 * j]; s += (v[j].x * v[j].x + v[j].y * v[j].y) + (v[j].z * v[j].z + v[j].w * v[j].w); }
        const float inv = 1.0f / sqrtf(wave_sum(s) * (1.f / D) + RMS_EPS);
#pragma unroll
        for (int j = 0; j < 4; ++j) o[64 * j] = (v[j] * inv) * *(const f32x4*)(g + 4 * F.lane + 256 * j);
    }
}
__device__ __forceinline__ void conv_phase(Frame& F, const bf16* PC, const float* cw, bf16* CVO) {
    const int gw = F.vcu * NWAVES + F.wave, NGW = F.G * NWAVES, c0 = F.lane * 8;
    float w[3][8];
#pragma unroll
    for (int k = 0; k < 3; ++k) { const f32x4 a = *(const f32x4*)(cw + k * CW + c0), b = *(const f32x4*)(cw + k * CW + c0 + 4);
        w[k][0] = a.x; w[k][1] = a.y; w[k][2] = a.z; w[k][3] = a.w; w[k][4] = b.x; w[k][5] = b.y; w[k][6] = b.z; w[k][7] = b.w; }
    for (int chunk = gw; chunk < M / 8; chunk += NGW) {
        const int t0 = chunk * 8; float v2[8], v1[8];
#pragma unroll
        for (int e = 0; e < 8; ++e) { v2[e] = 0.f; v1[e] = 0.f; }
        if ((t0 % SEQ) != 0) {
            const v4u c2 = *(const v4u*)(PC + (size_t)(t0 - 2) * PCP + 512 + c0), x2 = *(const v4u*)(PC + (size_t)(t0 - 2) * PCP + 1024 + c0);
            const v4u c1 = *(const v4u*)(PC + (size_t)(t0 - 1) * PCP + 512 + c0), x1 = *(const v4u*)(PC + (size_t)(t0 - 1) * PCP + 1024 + c0);
#pragma unroll
            for (int e = 0; e < 4; ++e) { v2[2 * e] = pg8::bflo(c2[e]) * pg8::bflo(x2[e]); v2[2 * e + 1] = pg8::bfhi(c2[e]) * pg8::bfhi(x2[e]);
                                          v1[2 * e] = pg8::bflo(c1[e]) * pg8::bflo(x1[e]); v1[2 * e + 1] = pg8::bfhi(c1[e]) * pg8::bfhi(x1[e]); }
        }
#pragma unroll
        for (int i = 0; i < 8; ++i) { const size_t t = (size_t)(t0 + i);
            const v4u cb = *(const v4u*)(PC + t * PCP + c0), cc = *(const v4u*)(PC + t * PCP + 512 + c0), cx = *(const v4u*)(PC + t * PCP + 1024 + c0);
            float v0[8], y[8];
#pragma unroll
            for (int e = 0; e < 4; ++e) { v0[2 * e] = pg8::bflo(cc[e]) * pg8::bflo(cx[e]); v0[2 * e + 1] = pg8::bfhi(cc[e]) * pg8::bfhi(cx[e]); }
#pragma unroll
            for (int e = 0; e < 8; ++e) { float a = w[0][e] * v2[e]; a = a + w[1][e] * v1[e]; a = a + w[2][e] * v0[e]; y[e] = a; v2[e] = v1[e]; v1[e] = v0[e]; }
            v4u o;
#pragma unroll
            for (int e = 0; e < 4; ++e) o[e] = pk2(pg8::bflo(cb[e]) * y[2 * e], pg8::bfhi(cb[e]) * y[2 * e + 1]);
            *(v4u*)(CVO + t * D + c0) = o; }
    }
}

struct Args { const float* in[18]; float* out; unsigned char* ws; int ph_lo, ph_hi; };
static_assert(sizeof(Args) == 20 * 8 + 8, "Args has no holes");
__global__ void __launch_bounds__(NWAVES * 64, 2) skel_fwd(Args args) {
    extern __shared__ __attribute__((aligned(16))) unsigned char lds[];
    Frame F;
    F.lds = (LAS unsigned char*)lds;
    F.MISC = (volatile LAS unsigned*)(F.lds + MISC_OFF);
    F.tid = threadIdx.x; F.lane = F.tid & 63; F.wave = __builtin_amdgcn_readfirstlane(F.tid >> 6);
    F.G = gridDim.x; { const int bx = blockIdx.x; F.vcu = (F.G % 8 == 0) ? (bx % 8) * (F.G / 8) + bx / 8 : bx; }
    unsigned char* ws = args.ws;
    F.ctl = (gu32*)(ws + WS_CTL);
    const float *x = args.in[0], *cin = args.in[1], *w_ada = args.in[2], *b_ada = args.in[3], *n1g = args.in[4], *wgu1 = args.in[5], *wd1 = args.in[6], *n2g = args.in[7], *wmix = args.in[8];
    const float *bmerge = args.in[9], *convw = args.in[10], *wco = args.in[11], *wao = args.in[12], *wout = args.in[13], *n3g = args.in[14], *wgu2 = args.in[15], *wd2 = args.in[16], *fing = args.in[17];
    float* H = args.out;
    float* mod = (float*)(ws + WS_MOD);
    bf16 *WGU1 = (bf16*)(ws + WS_WGU1), *WGU2 = (bf16*)(ws + WS_WGU2), *WD1 = (bf16*)(ws + WS_WD1), *WD2 = (bf16*)(ws + WS_WD2), *WMIX = (bf16*)(ws + WS_WMIX), *WCA = (bf16*)(ws + WS_WCA), *WO = (bf16*)(ws + WS_WO);
    bf16 *XN = (bf16*)(ws + WS_XN), *CVO = (bf16*)(ws + WS_CVO), *ACT = (bf16*)(ws + WS_ACT), *PQ = (bf16*)(ws + WS_PQ), *PC = (bf16*)(ws + WS_PC), *PG = (bf16*)(ws + WS_PG), *MERGED = (bf16*)(ws + WS_MERGED);
    float* STASH = (float*)(ws + WS_STASH);
    for (int u = F.tid; u < (LDS_BYTES - LDSCTL_OFF) / 4; u += NWAVES * 64) ((LAS unsigned*)(F.lds + LDSCTL_OFF))[u] = 0u;
    __syncthreads();
    XcdBarrier bar; bar.bar = (unsigned*)(F.ctl + CW_BAR); bar.x = 0; bar.st = nullptr;
    if (N_LAUNCHES == 1) bar = xcd_barrier_post((unsigned*)(F.ctl + CW_BAR), F.MISC + 8);
#define GRID_BAR() do { if (N_LAUNCHES == 1) xcd_barrier(bar); } while (0)
    const int lo = args.ph_lo, hi = args.ph_hi;
#define IN(k) (lo <= (k) && (k) < hi)
#define BOTH(k) (IN(k) && IN((k) + 1))
    const int bid = (int)blockIdx.x;

    if (IN(0)) {
        LAS float* cact = (LAS float*)(F.lds + RING_OFF + 73728); LAS float* red = (LAS float*)(F.lds + RING_OFF + 73728 + 16384);
        if (F.vcu < NMOD / 64) {
            for (int i = F.tid; i < NB * D; i += NWAVES * 64) cact[i] = silu_f(cin[i]);
            __syncthreads();
            for (int it = F.vcu; it < NMOD / 64; it += F.G) p0_mod_item(F, cact, red, w_ada, b_ada, mod, it);
        }
        LAS float* scr = (LAS float*)(F.lds + RING_OFF + F.wave * 8448);
        const int gw = F.vcu * NWAVES + F.wave, NGW = F.G * NWAVES;
        constexpr int I_GU = (D / 64) * (NGU / 32), I_D = (FF / 64) * (D / 32), I_MIX = (D / 64) * (NMIX / 32), I_C = (CW / 64) * (D / 32), I_O = (D / 64) * (D / 32);
        constexpr int NITEMS = 2 * I_GU + 2 * I_D + I_MIX + 2 * I_C + I_O;
        for (int it = gw; it < NITEMS; it += NGW) {
            int r = it;
            if (r < I_GU) { p0_transpose_item(wgu1, D, NGU, WGU1, D, 0, 1, scr, r, F.lane); continue; } r -= I_GU;
            if (r < I_GU) { p0_transpose_item(wgu2, D, NGU, WGU2, D, 0, 1, scr, r, F.lane); continue; } r -= I_GU;
            if (r < I_D) { p0_transpose_item(wd1, FF, D, WD1, FF, 0, 0, scr, r, F.lane); continue; } r -= I_D;
            if (r < I_D) { p0_transpose_item(wd2, FF, D, WD2, FF, 0, 0, scr, r, F.lane); continue; } r -= I_D;
            if (r < I_MIX) { p0_transpose_item(wmix, D, NMIX, WMIX, D, 0, 0, scr, r, F.lane); continue; } r -= I_MIX;
            if (r < I_C) { p0_transpose_item(wco, CW, D, WCA, D, 0, 0, scr, r, F.lane); continue; } r -= I_C;
            if (r < I_C) { p0_transpose_item(wao, AW, D, WCA, D, CW, 0, scr, r, F.lane); continue; } r -= I_C;
            p0_transpose_item(wout, D, D, WO, D, 0, 0, scr, r, F.lane);
        }
        if (BOTH(0)) GRID_BAR();
    }
    if (IN(1)) { rmsmod_phase(F, x, n1g, mod, 0, XN); if (BOTH(1)) GRID_BAR(); }
    if (IN(2)) {
        pg8::Gemm g{XN, WGU1, D, D, D, 0}; pg8::StaticOrder S; S.init(M, NGU, F.G, bid);
        pg8::EpiSwiGLU E{ACT, FF};
        pg8::gemm_phase<pg8::EpiSwiGLU, pg8::StaticOrder, true, true>(F.lds + RING_OFF, g, S, E);
        if (BOTH(2)) GRID_BAR();
    }
    if (IN(3)) {
        pg8::Gemm g{ACT, WD1, FF, FF, FF, 0}; pg8::StaticOrder S; S.init(M, D, F.G, bid);
        pg8::EpiResid E{x, H, mod + (0 * 3 + 2) * D, NMOD, SEQ, 0.5f};
        pg8::gemm_phase<pg8::EpiResid, pg8::StaticOrder, true, true>(F.lds + RING_OFF, g, S, E);
        if (BOTH(3)) GRID_BAR();
    }
    if (IN(4)) { rmsmod_phase(F, H, n2g, mod, 1, XN); if (BOTH(4)) GRID_BAR(); }
    if (IN(5)) {
        pg8::Gemm g{XN, WMIX, D, D, D, 0}; pg8::StaticOrder S; S.init(M, NMIX, F.G, bid);
        pg8::EpiMix E{PC, PQ, PG, QSCALE};
        pg8::gemm_phase<pg8::EpiMix, pg8::StaticOrder, true, true>(F.lds + RING_OFF, g, S, E);
        if (BOTH(5)) GRID_BAR();
    }
    if (IN(6)) {
        conv_phase(F, PC, convw, CVO);
        for (int v = F.vcu; v < NB * NH * 8; v += F.G) { const int bh = v >> 3, s = v & 7;
            sba::sb_unit(bh / NH, bh % NH, s, PQ, CVO, CW, (sba::lds_ptr)(F.lds + RING_OFF));
            sba::sb_unit(bh / NH, bh % NH, 15 - s, PQ, CVO, CW, (sba::lds_ptr)(F.lds + RING_OFF)); }
        if (BOTH(6)) GRID_BAR();
    }
    if (IN(7)) {
        pg8::Gemm g{CVO, WCA, D, D, 512, 512}; pg8::TwoPassOrder S; S.init(M, D, F.G, bid);
        pg8::EpiMerge E{STASH, MERGED, PG, bmerge};
        pg8::gemm_phase<pg8::EpiMerge, pg8::TwoPassOrder, true, true>(F.lds + RING_OFF, g, S, E);
        if (BOTH(7)) GRID_BAR();
    }
    if (IN(8)) {
        pg8::Gemm g{MERGED, WO, D, D, D, 0}; pg8::StaticOrder S; S.init(M, D, F.G, bid);
        pg8::EpiResid E{H, H, mod + (1 * 3 + 2) * D, NMOD, SEQ, 1.0f};
        pg8::gemm_phase<pg8::EpiResid, pg8::StaticOrder, true, true>(F.lds + RING_OFF, g, S, E);
        if (BOTH(8)) GRID_BAR();
    }
    if (IN(9)) { rmsmod_phase(F, H, n3g, mod, 2, XN); if (BOTH(9)) GRID_BAR(); }
    if (IN(10)) {
        pg8::Gemm g{XN, WGU2, D, D, D, 0}; pg8::StaticOrder S; S.init(M, NGU, F.G, bid);
        pg8::EpiSwiGLU E{ACT, FF};
        pg8::gemm_phase<pg8::EpiSwiGLU, pg8::StaticOrder, true, true>(F.lds + RING_OFF, g, S, E);
        if (BOTH(10)) GRID_BAR();
    }
    if (IN(11)) {
        pg8::Gemm g{ACT, WD2, FF, FF, FF, 0}; pg8::StaticOrder S; S.init(M, D, F.G, bid);
        pg8::EpiResid E{H, H, mod + (2 * 3 + 2) * D, NMOD, SEQ, 0.5f};
        pg8::gemm_phase<pg8::EpiResid, pg8::StaticOrder, true, true>(F.lds + RING_OFF, g, S, E);
        if (BOTH(11)) GRID_BAR();
    }
    if (IN(12)) {
        if (N_LAUNCHES == 1) { if (__hip_atomic_load((unsigned*)(F.ctl + CW_BAR) + XB_TMO, RLX_AGENT) != 0u) {
            const int gw = F.vcu * NWAVES + F.wave, NGW = F.G * NWAVES; const float q = __builtin_nanf("");
            for (int m = gw; m < M; m += NGW) { GAS f32x4* o = (GAS f32x4*)(H + (size_t)m * D) + F.lane;
#pragma unroll
                for (int j = 0; j < 4; ++j) o[64 * j] = (f32x4){q, q, q, q}; }
            return; } }
        final_phase(F, H, fing, H);
    }
#undef IN
#undef BOTH
#undef GRID_BAR
}

#if MK_N_LAUNCHES != 1
namespace ref {
__device__ __forceinline__ float sigm(float x) { return 1.f / (1.f + __expf(-x)); }
__global__ void k_mod(const float* c, const float* w_ada, const float* b_ada, float* mod) {
    const int n = blockIdx.x * 256 + threadIdx.x, b = blockIdx.y; float acc = b_ada[n];
    for (int k = 0; k < D; ++k) { const float cv = c[b * D + k]; acc += cv * sigm(cv) * w_ada[(size_t)k * NMOD + n]; }
    mod[b * NMOD + n] = acc;
}
template <int MODE> __global__ void k_transpose(const float* W, int K, int N, bf16* WT, int ldk, int koff) {
    const size_t i = (size_t)blockIdx.x * 256 + threadIdx.x; if (i >= (size_t)K * N) return;
    const int n_out = (int)(i / K), k = (int)(i % K); int src = n_out;
    if (MODE == 1) { const int tile = n_out >> 8, r = n_out & 255; src = (r < 128) ? 128 * tile + r : FF + 128 * tile + (r - 128); }
    WT[(size_t)n_out * ldk + koff + k] = (bf16)f2bf(W[(size_t)k * N + src]);
}
__global__ void k_rmsmod(const float* h, const float* g, const float* mod, int sub, bf16* out) {
    const int row = blockIdx.x * 4 + (threadIdx.x >> 6), lane = threadIdx.x & 63, b = row / SEQ;
    const float* hr = h + (size_t)row * D; float v[16]; float s = 0.f;
#pragma unroll
    for (int j = 0; j < 16; ++j) { v[j] = hr[lane + 64 * j]; s += v[j] * v[j]; }
#pragma unroll
    for (int o = 1; o < 64; o <<= 1) s += __shfl_xor(s, o);
    const float inv = rsqrtf(s * (1.f / D) + RMS_EPS);
    const float* sh = mod + b * NMOD + (sub * 3 + 0) * D; const float* sc = mod + b * NMOD + (sub * 3 + 1) * D;
#pragma unroll
    for (int j = 0; j < 16; ++j) { const int col = lane + 64 * j; out[(size_t)row * D + col] = (bf16)f2bf((v[j] * inv) * g[col] * (1.f + sc[col]) + sh[col]); }
}
__global__ void k_final(const float* h, const float* g, float* out) {
    const int row = blockIdx.x * 4 + (threadIdx.x >> 6), lane = threadIdx.x & 63;
    const float* hr = h + (size_t)row * D; float v[16]; float s = 0.f;
#pragma unroll
    for (int j = 0; j < 16; ++j) { v[j] = hr[lane + 64 * j]; s += v[j] * v[j]; }
#pragma unroll
    for (int o = 1; o < 64; o <<= 1) s += __shfl_xor(s, o);
    const float inv = rsqrtf(s * (1.f / D) + RMS_EPS);
#pragma unroll
    for (int j = 0; j < 16; ++j) { const int col = lane + 64 * j; out[(size_t)row * D + col] = (v[j] * inv) * g[col]; }
}
__device__ __forceinline__ float dot_bf16(const bf16* a, const bf16* b, int K) {
    float acc = 0.f;
    for (int k = 0; k < K; k += 8) { const uint4 va = *(const uint4*)(a + k), vb = *(const uint4*)(b + k); const unsigned* pa = (const unsigned*)&va; const unsigned* pb = (const unsigned*)&vb;
#pragma unroll
        for (int j = 0; j < 4; ++j) { acc += bf2f(pa[j] & 0xffffu) * bf2f(pb[j] & 0xffffu); acc += bf2f(pa[j] >> 16) * bf2f(pb[j] >> 16); } }
    return acc;
}
struct GemmArgs { const bf16* A; const bf16* Bt; const float* mod; const float* hin; float* hout; bf16* obf; float* stash; const bf16* pg; const float* bmerge; bf16* pqkv; bf16* pc; bf16* pgw; int lda, ldb, K, sub; float fac, qscale; };
template <int MODE> __global__ void k_gemm(GemmArgs g) {
    const int n = blockIdx.x * 16 + (threadIdx.x & 15), m = blockIdx.y * 16 + (threadIdx.x >> 4);
    const bf16* a = g.A + (size_t)m * g.lda;
    if (MODE == 0) { const int tile = n >> 7, r = n & 127;
        const float gg = dot_bf16(a, g.Bt + (size_t)(tile * 256 + r) * g.ldb, g.K), uu = dot_bf16(a, g.Bt + (size_t)(tile * 256 + 128 + r) * g.ldb, g.K);
        g.obf[(size_t)m * FF + n] = (bf16)f2bf(gg * sigm(gg) * uu);
    } else {
        const float acc = dot_bf16(a, g.Bt + (size_t)n * g.ldb, g.K); const int b = m / SEQ;
        if (MODE == 1) g.hout[(size_t)m * D + n] = g.hin[(size_t)m * D + n] + g.fac * g.mod[b * NMOD + (g.sub * 3 + 2) * D + n] * acc;
        if (MODE == 2) { if (n < 1536) g.pc[(size_t)m * PCP + n] = (bf16)f2bf(acc); else if (n < 3072) g.pqkv[(size_t)m * PQP + (n - 1536)] = (bf16)f2bf(n < 2048 ? acc * g.qscale : acc); else g.pgw[(size_t)m * PGP + (n - 3072)] = (bf16)f2bf(acc); }
        if (MODE == 3) g.stash[(size_t)m * D + n] = sigm(bf2f(g.pg[(size_t)m * PGP + n]) + g.bmerge[n]) * acc;
        if (MODE == 4) g.obf[(size_t)m * D + n] = (bf16)f2bf(g.stash[(size_t)m * D + n] + sigm(bf2f(g.pg[(size_t)m * PGP + D + n]) + g.bmerge[D + n]) * acc);
    }
}
__global__ void k_conv(const bf16* pc, const float* cw, bf16* cvo) {
    const size_t i = (size_t)blockIdx.x * 256 + threadIdx.x; const int t = (int)(i / CW), c = (int)(i % CW), pos = t % SEQ; float y = 0.f;
#pragma unroll
    for (int k = 0; k < 3; ++k) { const int dt = 2 - k; if (pos - dt >= 0) { const bf16* r = pc + (size_t)(t - dt) * PCP; y += cw[k * CW + c] * (bf2f(r[512 + c]) * bf2f(r[1024 + c])); } }
    cvo[(size_t)t * D + c] = (bf16)f2bf(bf2f(pc[(size_t)t * PCP + c]) * y);
}
__global__ void __launch_bounds__(64) k_attn(const bf16* pqkv, bf16* cvo) {
    const int t = blockIdx.x * 64 + threadIdx.x, h = blockIdx.y, b = blockIdx.z; const size_t row = (size_t)b * SEQ + t;
    float q[HD], o[HD];
#pragma unroll
    for (int d = 0; d < HD; ++d) { q[d] = bf2f(pqkv[row * PQP + h * HD + d]); o[d] = 0.f; }
    float R = 0.f;
    for (int s = t - 1; s >= 0; --s) { const bf16* kr = pqkv + ((size_t)b * SEQ + s) * PQP + 512 + h * HD; const bf16* vr = kr + 512; float z = 0.f;
#pragma unroll
        for (int d = 0; d < HD; ++d) z += q[d] * bf2f(kr[d]);
        const float sp = fmaxf(z, 0.f) + log2f(1.f + exp2f(-fabsf(z))); const float a = exp2f(z - sp - R);
#pragma unroll
        for (int d = 0; d < HD; ++d) o[d] += a * bf2f(vr[d]);
        R += sp; if (R > sba::THR2) break; }
#pragma unroll
    for (int d = 0; d < HD; ++d) cvo[row * D + 512 + h * HD + d] = (bf16)f2bf(o[d]);
}
static void run_phase(int k, void* const* d_in, float* Hout, unsigned char* ws, hipStream_t stream) {
    const float* x = (const float*)d_in[0]; const float* c = (const float*)d_in[1]; const float* w_ada = (const float*)d_in[2]; const float* b_ada = (const float*)d_in[3];
    const float* n1g = (const float*)d_in[4]; const float* wgu1 = (const float*)d_in[5]; const float* wd1 = (const float*)d_in[6]; const float* n2g = (const float*)d_in[7];
    const float* wmix = (const float*)d_in[8]; const float* bmerge = (const float*)d_in[9]; const float* convw = (const float*)d_in[10]; const float* wco = (const float*)d_in[11];
    const float* wao = (const float*)d_in[12]; const float* wout = (const float*)d_in[13]; const float* n3g = (const float*)d_in[14]; const float* wgu2 = (const float*)d_in[15];
    const float* wd2 = (const float*)d_in[16]; const float* fg = (const float*)d_in[17];
    float* H = Hout; float* mod = (float*)(ws + WS_MOD);
    bf16 *WGU1 = (bf16*)(ws + WS_WGU1), *WGU2 = (bf16*)(ws + WS_WGU2), *WD1 = (bf16*)(ws + WS_WD1), *WD2 = (bf16*)(ws + WS_WD2), *WMIX = (bf16*)(ws + WS_WMIX), *WCA = (bf16*)(ws + WS_WCA), *WO = (bf16*)(ws + WS_WO);
    bf16 *XN = (bf16*)(ws + WS_XN), *CVO = (bf16*)(ws + WS_CVO), *ACT = (bf16*)(ws + WS_ACT), *PQ = (bf16*)(ws + WS_PQ), *PC = (bf16*)(ws + WS_PC), *PG = (bf16*)(ws + WS_PG), *MERGED = (bf16*)(ws + WS_MERGED);
    float* STASH = (float*)(ws + WS_STASH);
    GemmArgs g;
#define GZ() memset(&g, 0, sizeof g)
#define TR(MODE, W, K, N, WT, ldk, koff) k_transpose<MODE><<<(unsigned)(((size_t)(K) * (N) + 255) / 256), 256, 0, stream>>>(W, K, N, WT, ldk, koff)
    switch (k) {
    case 0: k_mod<<<dim3(NMOD / 256, NB), 256, 0, stream>>>(c, w_ada, b_ada, mod);
        TR(1, wgu1, D, NGU, WGU1, D, 0); TR(1, wgu2, D, NGU, WGU2, D, 0); TR(0, wd1, FF, D, WD1, FF, 0); TR(0, wd2, FF, D, WD2, FF, 0);
        TR(0, wmix, D, NMIX, WMIX, D, 0); TR(0, wco, CW, D, WCA, D, 0); TR(0, wao, AW, D, WCA, D, CW); TR(0, wout, D, D, WO, D, 0); break;
    case 1: k_rmsmod<<<M / 4, 256, 0, stream>>>(x, n1g, mod, 0, XN); break;
    case 2: GZ(); g.A = XN; g.lda = D; g.Bt = WGU1; g.ldb = D; g.K = D; g.obf = ACT; k_gemm<0><<<dim3(FF / 16, M / 16), 256, 0, stream>>>(g); break;
    case 3: GZ(); g.A = ACT; g.lda = FF; g.Bt = WD1; g.ldb = FF; g.K = FF; g.mod = mod; g.hin = x; g.hout = H; g.sub = 0; g.fac = 0.5f; k_gemm<1><<<dim3(D / 16, M / 16), 256, 0, stream>>>(g); break;
    case 4: k_rmsmod<<<M / 4, 256, 0, stream>>>(H, n2g, mod, 1, XN); break;
    case 5: GZ(); g.A = XN; g.lda = D; g.Bt = WMIX; g.ldb = D; g.K = D; g.pc = PC; g.pqkv = PQ; g.pgw = PG; g.qscale = QSCALE; k_gemm<2><<<dim3(NMIX / 16, M / 16), 256, 0, stream>>>(g); break;
    case 6: k_conv<<<(unsigned)((size_t)M * CW / 256), 256, 0, stream>>>(PC, convw, CVO); k_attn<<<dim3(SEQ / 64, NH, NB), 64, 0, stream>>>(PQ, CVO); break;
    case 7: GZ(); g.A = CVO; g.lda = D; g.Bt = WCA; g.ldb = D; g.K = 512; g.stash = STASH; g.pg = PG; g.bmerge = bmerge; k_gemm<3><<<dim3(D / 16, M / 16), 256, 0, stream>>>(g);
            GZ(); g.A = CVO + 512; g.lda = D; g.Bt = WCA + 512; g.ldb = D; g.K = 512; g.stash = STASH; g.pg = PG; g.bmerge = bmerge; g.obf = MERGED; k_gemm<4><<<dim3(D / 16, M / 16), 256, 0, stream>>>(g); break;
    case 8: GZ(); g.A = MERGED; g.lda = D; g.Bt = WO; g.ldb = D; g.K = D; g.mod = mod; g.hin = H; g.hout = H; g.sub = 1; g.fac = 1.0f; k_gemm<1><<<dim3(D / 16, M / 16), 256, 0, stream>>>(g); break;
    case 9: k_rmsmod<<<M / 4, 256, 0, stream>>>(H, n3g, mod, 2, XN); break;
    case 10: GZ(); g.A = XN; g.lda = D; g.Bt = WGU2; g.ldb = D; g.K = D; g.obf = ACT; k_gemm<0><<<dim3(FF / 16, M / 16), 256, 0, stream>>>(g); break;
    case 11: GZ(); g.A = ACT; g.lda = FF; g.Bt = WD2; g.ldb = FF; g.K = FF; g.mod = mod; g.hin = H; g.hout = H; g.sub = 2; g.fac = 0.5f; k_gemm<1><<<dim3(D / 16, M / 16), 256, 0, stream>>>(g); break;
    default: k_final<<<M / 4, 256, 0, stream>>>(H, fg, H); break;
    }
#undef GZ
#undef TR
}
}
#endif

extern "C" void kernel_launch(void* const* d_in, const int* in_sizes, int n_in, void* d_out, int out_size, void* d_ws, size_t ws_size, hipStream_t stream) {
    static int grid = 0;
    if (grid == 0) {
        if (n_in != 18 || in_sizes[0] != M * D || out_size != M * D || ws_size < WS_END) { fprintf(stderr, "kernel_launch: built for 18 inputs, x and out of %d floats, >= %zu bytes of workspace; got n_in %d, out %d, ws %zu; nothing launched\n", M * D, (size_t)WS_END, n_in, out_size, ws_size); grid = -1; return; }
        int dev = 0, cus = 0, per_cu = 0;
        if (hipGetDevice(&dev) != hipSuccess || hipDeviceGetAttribute(&cus, hipDeviceAttributeMultiprocessorCount, dev) != hipSuccess) { fprintf(stderr, "kernel_launch: hipGetDevice / hipDeviceGetAttribute failed; nothing launched\n"); grid = -1; return; }
        if (hipFuncSetAttribute((const void*)skel_fwd, hipFuncAttributeMaxDynamicSharedMemorySize, LDS_BYTES) != hipSuccess) { fprintf(stderr, "kernel_launch: hipFuncSetAttribute failed (%d bytes of dynamic LDS); nothing launched\n", LDS_BYTES); grid = -1; return; }
        if (hipOccupancyMaxActiveBlocksPerMultiprocessor(&per_cu, (const void*)skel_fwd, NWAVES * 64, LDS_BYTES) != hipSuccess || per_cu < 1) { fprintf(stderr, "kernel_launch: occupancy query reports %d workgroups per CU; nothing launched\n", per_cu); (void)hipGetLastError(); grid = -1; return; }
        grid = cus;
    }
    if (grid < 0) return;
    if (hipMemsetAsync((char*)d_ws + WS_CTL, 0, CTL_ZERO_BYTES, stream) != hipSuccess) { fprintf(stderr, "kernel_launch: hipMemsetAsync of the control words failed; nothing launched\n"); return; }
    Args a; memset(&a, 0, sizeof a);
    for (int i = 0; i < 18; ++i) a.in[i] = (const float*)d_in[i];
    a.out = (float*)d_out; a.ws = (unsigned char*)d_ws;
#if MK_N_LAUNCHES == 1
    a.ph_lo = 0; a.ph_hi = N_PHASES;
    hipLaunchKernelGGL(skel_fwd, dim3(grid), dim3(NWAVES * 64), LDS_BYTES, stream, a);
    { const hipError_t le = hipPeekAtLastError(); if (le != hipSuccess) fprintf(stderr, "kernel_launch: launch failed: %s (grid %d x %d threads, %d B LDS)\n", hipGetErrorName(le), grid, NWAVES * 64, LDS_BYTES); }
#else
    for (int k = 0; k < N_PHASES; ++k) {
        if ((MK_NAIVE_MASK >> k) & 1u) { ref::run_phase(k, d_in, (float*)d_out, (unsigned char*)d_ws, stream); continue; }
        a.ph_lo = k; a.ph_hi = k + 1;
        hipLaunchKernelGGL(skel_fwd, dim3(grid), dim3(NWAVES * 64), LDS_BYTES, stream, a);
        const hipError_t le = hipPeekAtLastError(); if (le != hipSuccess) { fprintf(stderr, "kernel_launch: launch %d failed: %s\n", k, hipGetErrorName(le)); break; }
    }
#endif
}
```
